# Optimizing an MI355X kernel written in HIP

```python
import math
import jax, jax.numpy as jnp
from jax import lax
import numpy as np

D_MODEL = 1024
BATCH = 2
SEQ = 8192
DEPTH = 2
DEC_BATCH = 32
DEC_SEQ = 4
PAST_LEN = 16384
PAGE_SIZE = 128

N_A_LAYERS = DEPTH // 2
N_B_LAYERS = DEPTH - N_A_LAYERS

POOL_WINDOWS = (2, 4, 8, 16)
N_POOL_GROUPS = len(POOL_WINDOWS)
POOL_CH = D_MODEL // N_POOL_GROUPS
POOL_BUF = max(POOL_WINDOWS) - 1

HEAD_DIM = 64
ATTN_WINDOWS = (128, 512, 2048)
ATTN_DILATIONS = (1, 4, 16)
N_ATTN_GROUPS = len(ATTN_WINDOWS)
KV_PER_GROUP = 2
Q_PER_KV = 3
HEADS_PER_GROUP = KV_PER_GROUP * Q_PER_KV
N_Q_HEADS = N_ATTN_GROUPS * HEADS_PER_GROUP
N_KV_HEADS = N_ATTN_GROUPS * KV_PER_GROUP
Q_WIDTH = N_Q_HEADS * HEAD_DIM
KV_WIDTH = N_KV_HEADS * HEAD_DIM
KV_WINDOW = max(ATTN_WINDOWS)
Q_BLOCK = 128
ROPE_THETA = 10000.0

D_FF = 4 * D_MODEL
EPS = 1e-6

kernel_name = "yoco_pool_dilated_swa_decoder_step"


def _rmsnorm(x, g):
    xf = x.astype(jnp.float32)
    y = xf * lax.rsqrt(jnp.mean(xf * xf, axis=-1, keepdims=True) + EPS) * g.astype(jnp.float32)
    return y.astype(x.dtype)


def _rope(x, pos):
    inv = ROPE_THETA ** (-jnp.arange(0, HEAD_DIM, 2, dtype=jnp.float32) / HEAD_DIM)
    ang = pos.astype(jnp.float32)[:, None] * inv[None, :]
    cos = jnp.cos(ang)[None, :, None, :]
    sin = jnp.sin(ang)[None, :, None, :]
    xf = x.astype(jnp.float32)
    x1, x2 = xf[..., : HEAD_DIM // 2], xf[..., HEAD_DIM // 2:]
    return jnp.concatenate([x1 * cos - x2 * sin, x2 * cos + x1 * sin], axis=-1).astype(x.dtype)


def _pool_mix(u, buf, start_pos, w_pool, pool_scale):
    B, T, D = u.shape
    P = buf.shape[1]
    ue = jnp.concatenate([buf, u], axis=1).astype(jnp.float32)
    cs = jnp.concatenate([jnp.zeros((B, 1, D), jnp.float32), jnp.cumsum(ue, axis=1)], axis=1)
    cs = cs.reshape(B, P + T + 1, N_POOL_GROUPS, POOL_CH)
    hi = P + 1 + jnp.arange(T)
    pos = start_pos + jnp.arange(T)
    means = []
    for g, w in enumerate(POOL_WINDOWS):
        lo = jnp.maximum(hi - w, 0)
        cnt = jnp.minimum(w, pos + 1).astype(jnp.float32)
        means.append((cs[:, hi, g] - cs[:, lo, g]) / cnt[None, :, None])
    mean = jnp.stack(means, axis=2)
    pooled = (mean - u.reshape(B, T, N_POOL_GROUPS, POOL_CH).astype(jnp.float32)).astype(u.dtype)
    y = jnp.einsum('btgc,gce->btge', pooled, w_pool).reshape(B, T, D)
    return y * pool_scale


def _dilated_group_attn(q, k, v, key_offset, window, dilation):
    B, Tq = q.shape[0], q.shape[1]
    qb = math.gcd(Tq, Q_BLOCK)
    nb = Tq // qb
    steps = jnp.arange(window // dilation + 1) * dilation
    scale = HEAD_DIM ** -0.5

    def block(args):
        qi, start = args
        kpos = start + key_offset + jnp.arange(qb)[:, None] - steps[None, :]
        valid = kpos >= 0
        kpos = jnp.maximum(kpos, 0)
        kg = k[:, kpos]
        vg = v[:, kpos]
        s = jnp.einsum('bqgrd,bqkgd->bqgrk', qi, kg, preferred_element_type=jnp.float32) * scale
        s = jnp.where(valid[None, :, None, None, :], s, -jnp.inf)
        lse = jax.nn.logsumexp(s, axis=-1)
        p = jnp.exp(s - lse[..., None]).astype(vg.dtype)
        o = jnp.einsum('bqgrk,bqkgd->bqgrd', p, vg)
        return o, lse

    qs = jnp.swapaxes(q.reshape((B, nb, qb) + q.shape[2:]), 0, 1)
    starts = jnp.arange(nb) * qb
    o, lse = lax.map(block, (qs, starts))
    o = jnp.swapaxes(o, 0, 1).reshape(q.shape)
    lse = jnp.swapaxes(lse, 0, 1).reshape(q.shape[:-1])
    return o, lse


def _dilated_mixer(u, pos, k_all, v_all, key_offset, w_q, w_o):
    B, T, _ = u.shape
    q = _rope((u @ w_q).reshape(B, T, N_Q_HEADS, HEAD_DIM), pos)
    q = q.reshape(B, T, N_ATTN_GROUPS, KV_PER_GROUP, Q_PER_KV, HEAD_DIM)
    outs, lses = [], []
    for g in range(N_ATTN_GROUPS):
        kg = k_all[:, :, g * KV_PER_GROUP:(g + 1) * KV_PER_GROUP]
        vg = v_all[:, :, g * KV_PER_GROUP:(g + 1) * KV_PER_GROUP]
        o, l = _dilated_group_attn(q[:, :, g], kg, vg, key_offset, ATTN_WINDOWS[g], ATTN_DILATIONS[g])
        outs.append(o.reshape(B, T, HEADS_PER_GROUP, HEAD_DIM))
        lses.append(l.reshape(B, T, HEADS_PER_GROUP))
    alpha = jax.nn.softmax(jnp.stack(lses, axis=2), axis=2)
    o = jnp.stack(outs, axis=2) * alpha[..., None].astype(u.dtype)
    return o.reshape(B, T, Q_WIDTH) @ w_o


def _trunk(x, start_pos, pool_bufs, cache_k, cache_v, norm_gains, kv_norm_gain, w_pool, pool_scale,
           w_q, w_o, w_kv, w_up, w_down):
    B, T, _ = x.shape
    pos = start_pos + jnp.arange(T)
    new_pool = []
    k_new = v_new = k_all = v_all = None
    for layer in range(DEPTH):
        g = norm_gains[layer]
        u = _rmsnorm(x, g[0])
        if layer < N_A_LAYERS:
            buf = pool_bufs[layer]
            mix = _pool_mix(u, buf, start_pos, w_pool[layer], pool_scale[layer])
            new_pool.append(jnp.concatenate([buf, u], axis=1)[:, -POOL_BUF:])
        else:
            if layer == N_A_LAYERS:
                kv = _rmsnorm(x, kv_norm_gain) @ w_kv
                k_new = _rope(kv[..., :KV_WIDTH].reshape(B, T, N_KV_HEADS, HEAD_DIM), pos)
                v_new = kv[..., KV_WIDTH:].reshape(B, T, N_KV_HEADS, HEAD_DIM)
                k_all = jnp.concatenate([cache_k, k_new], axis=1)
                v_all = jnp.concatenate([cache_v, v_new], axis=1)
            b = layer - N_A_LAYERS
            mix = _dilated_mixer(u, pos, k_all, v_all, cache_k.shape[1], w_q[b], w_o[b])
        x = x + _rmsnorm(mix, g[1])
        h = _rmsnorm(x, g[2])
        ff = jnp.square(jax.nn.relu(h @ w_up[layer])) @ w_down[layer]
        x = x + _rmsnorm(ff, g[3])
    return x, jnp.stack(new_pool, axis=0), k_new, v_new


def setup_inputs(seed: int = 0) -> dict:
    key = jax.random.key(seed)
    ks = jax.random.split(key, 14)
    f32 = jnp.float32
    kv_buf = min(KV_WINDOW, PAST_LEN)
    nrm = lambda k, s: jax.random.normal(k, s, f32)
    return {
        "x_prompt": nrm(ks[0], (BATCH, SEQ, D_MODEL)),
        "x_sample": nrm(ks[1], (DEC_BATCH, DEC_SEQ, D_MODEL)),
        "cache_pool": nrm(ks[2], (N_A_LAYERS, DEC_BATCH, POOL_BUF, D_MODEL)),
        "cache_k": nrm(ks[3], (DEC_BATCH, kv_buf, N_KV_HEADS, HEAD_DIM)),
        "cache_v": nrm(ks[4], (DEC_BATCH, kv_buf, N_KV_HEADS, HEAD_DIM)),
        "norm_gains": 1.0 + 0.05 * nrm(ks[5], (DEPTH, 4, D_MODEL)),
        "kv_norm_gain": 1.0 + 0.05 * nrm(ks[6], (D_MODEL,)),
        "w_pool": nrm(ks[7], (N_A_LAYERS, N_POOL_GROUPS, POOL_CH, POOL_CH)) * POOL_CH ** -0.5,
        "pool_scale": 1.0 + 0.1 * nrm(ks[8], (N_A_LAYERS, D_MODEL)),
        "w_q": nrm(ks[9], (N_B_LAYERS, D_MODEL, Q_WIDTH)) * D_MODEL ** -0.5,
        "w_o": nrm(ks[10], (N_B_LAYERS, Q_WIDTH, D_MODEL)) * Q_WIDTH ** -0.5,
        "w_kv": nrm(ks[11], (D_MODEL, 2 * KV_WIDTH)) * D_MODEL ** -0.5,
        "w_up": nrm(ks[12], (DEPTH, D_MODEL, D_FF)) * D_MODEL ** -0.5,
        "w_down": nrm(ks[13], (DEPTH, D_FF, D_MODEL)) * D_FF ** -0.5,
    }


def reference(x_prompt, x_sample, cache_pool, cache_k, cache_v, norm_gains, kv_norm_gain, w_pool,
              pool_scale, w_q, w_o, w_kv, w_up, w_down):
    bp = x_prompt.shape[0]
    dt = x_prompt.dtype
    empty_pool = jnp.zeros((N_A_LAYERS, bp, 0, D_MODEL), dt)
    empty_kv = jnp.zeros((bp, 0, N_KV_HEADS, HEAD_DIM), dt)
    y_prompt, pool_prompt, k_p, v_p = _trunk(
        x_prompt, 0, empty_pool, empty_kv, empty_kv, norm_gains, kv_norm_gain, w_pool, pool_scale,
        w_q, w_o, w_kv, w_up, w_down)
    y_sample, pool_sample, k_s, v_s = _trunk(
        x_sample, PAST_LEN, cache_pool, cache_k, cache_v, norm_gains, kv_norm_gain, w_pool, pool_scale,
        w_q, w_o, w_kv, w_up, w_down)
    k_prompt = k_p[:, -KV_WINDOW:]
    v_prompt = v_p[:, -KV_WINDOW:]
    return (y_prompt, y_sample, pool_prompt, k_prompt, v_prompt, pool_sample, k_s, v_s)
```

```cpp
#include <hip/hip_runtime.h>
#include <cstdint>
#include <cstdio>

namespace v1 {
constexpr int D = 1024, FF = 4096, SEQ = 8192, NPB = 2, NSB = 32, NST = 4, MP = NPB * SEQ, MS = NSB * NST, MT = MP + MS;
constexpr int QW = 1152, KVW = 384, CACHE = 2048, PAST = 16384;
constexpr float EPS = 1e-6f;

__device__ __forceinline__ float wave_sum(float v) {
#pragma unroll
    for (int o = 1; o < 64; o <<= 1) v += __shfl_xor(v, o);
    return v;
}
__device__ __forceinline__ float wave_max(float v) {
#pragma unroll
    for (int o = 1; o < 64; o <<= 1) v = fmaxf(v, __shfl_xor(v, o));
    return v;
}

__global__ __launch_bounds__(256) void k_rmsnorm(const float* in, const float* res, const float* g, float* out, const float* g2, float* out2, int rows) {
    const int row = blockIdx.x * 4 + (threadIdx.x >> 6), lane = threadIdx.x & 63;
    if (row >= rows) return;
    const float4* x = (const float4*)(in + (size_t)row * D);
    float4 v[4]; float s = 0.f;
#pragma unroll
    for (int j = 0; j < 4; ++j) { v[j] = x[lane + 64 * j]; s += v[j].x * v[j].x + v[j].y * v[j].y + v[j].z * v[j].z + v[j].w * v[j].w; }
    s = wave_sum(s);
    const float r = rsqrtf(s * (1.f / D) + EPS);
#pragma unroll
    for (int j = 0; j < 4; ++j) {
        const float4 gg = ((const float4*)g)[lane + 64 * j];
        float4 o = {v[j].x * r * gg.x, v[j].y * r * gg.y, v[j].z * r * gg.z, v[j].w * r * gg.w};
        if (out2) { const float4 g2v = ((const float4*)g2)[lane + 64 * j];
            ((float4*)(out2 + (size_t)row * D))[lane + 64 * j] = float4{v[j].x * r * g2v.x, v[j].y * r * g2v.y, v[j].z * r * g2v.z, v[j].w * r * g2v.w}; }
        if (res) { const float4 rr = ((const float4*)(res + (size_t)row * D))[lane + 64 * j]; o.x += rr.x; o.y += rr.y; o.z += rr.z; o.w += rr.w; }
        ((float4*)(out + (size_t)row * D))[lane + 64 * j] = o;
    }
}

__global__ __launch_bounds__(256) void k_pool_prep(const float* U, const float* cache_pool, float* P) {
    const int idx = blockIdx.x * 256 + threadIdx.x;
    if (idx >= MT * 256) return;
    const int row = idx >> 8, c4 = idx & 255, col = c4 * 4, grp = col >> 8, w = 2 << grp;
    float4 s = {0.f, 0.f, 0.f, 0.f}; float cnt;
    if (row < MP) {
        const int t = row & (SEQ - 1);
        for (int j = 0; j < w; ++j) if (t - j >= 0) { const float4 u = *(const float4*)(U + (size_t)(row - j) * D + col); s.x += u.x; s.y += u.y; s.z += u.z; s.w += u.w; }
        cnt = (float)(w < t + 1 ? w : t + 1);
    } else {
        const int r = row - MP, b = r >> 2, t = r & 3;
        for (int j = 0; j < w; ++j) {
            float4 u;
            if (t - j >= 0) u = *(const float4*)(U + (size_t)(row - j) * D + col);
            else u = *(const float4*)(cache_pool + ((size_t)b * 15 + (15 + t - j)) * D + col);
            s.x += u.x; s.y += u.y; s.z += u.z; s.w += u.w;
        }
        cnt = (float)w;
    }
    const float4 u0 = *(const float4*)(U + (size_t)row * D + col);
    float4 o = {s.x / cnt - u0.x, s.y / cnt - u0.y, s.z / cnt - u0.z, s.w / cnt - u0.w};
    *(float4*)(P + (size_t)row * D + col) = o;
}

__global__ __launch_bounds__(256) void k_pool_out(const float* U, const float* cache_pool, float* pool_prompt, float* pool_sample) {
    const int idx = blockIdx.x * 256 + threadIdx.x;
    const int NP = NPB * 15 * D, NS = NSB * 15 * D;
    if (idx < NP) { const int c = idx % D, i = (idx / D) % 15, b = idx / (15 * D); pool_prompt[idx] = U[((size_t)b * SEQ + SEQ - 15 + i) * D + c]; }
    else if (idx < NP + NS) { const int k = idx - NP; const int c = k % D, i = (k / D) % 15, b = k / (15 * D);
        pool_sample[k] = i < 11 ? cache_pool[((size_t)b * 15 + 4 + i) * D + c] : U[((size_t)MP + b * 4 + (i - 11)) * D + c]; }
}

template <int EPI>
__global__ __launch_bounds__(256) void k_gemm(const float* A, int lda, const float* B, int ldb, float* C, int ldc, int K, const float* colscale,
                                              long zA, long zB, long zC, long zS) {
    __shared__ float As[16][68];
    __shared__ float Bs[16][68];
    const int z = blockIdx.z; A += z * zA; B += z * zB; C += z * zC; if (EPI == 2) colscale += z * zS;
    const int tid = threadIdx.x, tx = tid & 15, ty = tid >> 4;
    const int m0 = blockIdx.y * 64, n0 = blockIdx.x * 64;
    float acc[4][4];
#pragma unroll
    for (int i = 0; i < 4; ++i)
#pragma unroll
        for (int j = 0; j < 4; ++j) acc[i][j] = 0.f;
    for (int k0 = 0; k0 < K; k0 += 16) {
        const float4 a = *(const float4*)(A + (size_t)(m0 + (tid >> 2)) * lda + k0 + (tid & 3) * 4);
        As[(tid & 3) * 4 + 0][tid >> 2] = a.x; As[(tid & 3) * 4 + 1][tid >> 2] = a.y; As[(tid & 3) * 4 + 2][tid >> 2] = a.z; As[(tid & 3) * 4 + 3][tid >> 2] = a.w;
        const float4 b = *(const float4*)(B + (size_t)(k0 + (tid >> 4)) * ldb + n0 + (tid & 15) * 4);
        *(float4*)&Bs[tid >> 4][(tid & 15) * 4] = b;
        __syncthreads();
#pragma unroll
        for (int kk = 0; kk < 16; ++kk) {
            const float4 av = *(const float4*)&As[kk][ty * 4];
            const float4 bv = *(const float4*)&Bs[kk][tx * 4];
            const float aa[4] = {av.x, av.y, av.z, av.w}, bb[4] = {bv.x, bv.y, bv.z, bv.w};
#pragma unroll
            for (int i = 0; i < 4; ++i)
#pragma unroll
                for (int j = 0; j < 4; ++j) acc[i][j] += aa[i] * bb[j];
        }
        __syncthreads();
    }
#pragma unroll
    for (int i = 0; i < 4; ++i) {
        float4 o = {acc[i][0], acc[i][1], acc[i][2], acc[i][3]};
        if (EPI == 1) { o.x = o.x > 0.f ? o.x * o.x : 0.f; o.y = o.y > 0.f ? o.y * o.y : 0.f; o.z = o.z > 0.f ? o.z * o.z : 0.f; o.w = o.w > 0.f ? o.w * o.w : 0.f; }
        if (EPI == 2) { const float4 s = *(const float4*)(colscale + n0 + tx * 4); o.x *= s.x; o.y *= s.y; o.z *= s.z; o.w *= s.w; }
        *(float4*)(C + (size_t)(m0 + ty * 4 + i) * ldc + n0 + tx * 4) = o;
    }
}

__device__ __forceinline__ int row_pos(int row) { return row < MP ? (row & (SEQ - 1)) : PAST + ((row - MP) & 3); }

__global__ __launch_bounds__(256) void k_rope(const float* src, int lds_, int coff, float* dst, int ldd, int nheads) {
    const int idx = blockIdx.x * 256 + threadIdx.x;
    if (idx >= MT * nheads * 32) return;
    const int i = idx & 31, h = (idx >> 5) % nheads, row = idx / (32 * nheads);
    const float inv = (float)pow(10000.0, -(double)(2 * i) / 64.0);
    const float ang = (float)row_pos(row) * inv;
    const float c = (float)cos((double)ang), s = (float)sin((double)ang);
    const float x1 = src[(size_t)row * lds_ + coff + h * 64 + i], x2 = src[(size_t)row * lds_ + coff + h * 64 + 32 + i];
    dst[(size_t)row * ldd + h * 64 + i] = x1 * c - x2 * s;
    dst[(size_t)row * ldd + h * 64 + 32 + i] = x2 * c + x1 * s;
}
__global__ __launch_bounds__(256) void k_copy_cols(const float* src, int lds_, int coff, float* dst, int ldd, int ncols) {
    const int idx = blockIdx.x * 256 + threadIdx.x;
    if (idx >= MT * ncols) return;
    const int c = idx % ncols, row = idx / ncols;
    dst[(size_t)row * ldd + c] = src[(size_t)row * lds_ + coff + c];
}

__global__ __launch_bounds__(256) void k_attn(const float* Q, const float* KB, const float* VB, const float* cache_k, const float* cache_v, float* OG, float* LSE) {
    const int wid = blockIdx.x * 4 + (threadIdx.x >> 6), lane = threadIdx.x & 63;
    if (wid >= MT * 18) return;
    const int row = wid / 18, hq = wid % 18, g = hq / 6, hh = hq % 6, kvh = g * 2 + hh / 3;
    const int dil = g == 0 ? 1 : (g == 1 ? 4 : 16);
    const float* q = Q + (size_t)row * QW + hq * 64;
    const bool is_s = row >= MP;
    int b, t; if (!is_s) { b = row >> 13; t = row & (SEQ - 1); } else { b = (row - MP) >> 2; t = (row - MP) & 3; }
    float sc[3]; const float* krow[3]; const float* vrow[3];
#pragma unroll
    for (int j = 0; j < 3; ++j) {
        const int s = lane + 64 * j; sc[j] = -INFINITY; krow[j] = nullptr; vrow[j] = nullptr;
        if (s <= 128) {
            if (!is_s) { const int kp = t - s * dil; if (kp >= 0) { krow[j] = KB + (size_t)(b * SEQ + kp) * KVW + kvh * 64; vrow[j] = VB + (size_t)(b * SEQ + kp) * KVW + kvh * 64; } }
            else { const int kp = CACHE + t - s * dil;
                if (kp >= CACHE) { krow[j] = KB + (size_t)(MP + b * 4 + (kp - CACHE)) * KVW + kvh * 64; vrow[j] = VB + (size_t)(MP + b * 4 + (kp - CACHE)) * KVW + kvh * 64; }
                else { krow[j] = cache_k + ((size_t)b * CACHE + kp) * KVW + kvh * 64; vrow[j] = cache_v + ((size_t)b * CACHE + kp) * KVW + kvh * 64; } }
            if (krow[j]) { float a = 0.f; for (int d = 0; d < 64; ++d) a += q[d] * krow[j][d]; sc[j] = a * 0.125f; }
        }
    }
    const float m = wave_max(fmaxf(sc[0], fmaxf(sc[1], sc[2])));
    float p[3], l = 0.f;
#pragma unroll
    for (int j = 0; j < 3; ++j) { p[j] = krow[j] ? expf(sc[j] - m) : 0.f; l += p[j]; }
    l = wave_sum(l);
    float o = 0.f;
#pragma unroll
    for (int j = 0; j < 3; ++j) {
        for (int sl = 0; sl < 64; ++sl) {
            const float pj = __shfl(p[j], sl);
            const unsigned long long vp = (unsigned long long)vrow[j];
            const unsigned lo = __shfl((unsigned)vp, sl), hi = __shfl((unsigned)(vp >> 32), sl);
            const float* vr = (const float*)(((unsigned long long)hi << 32) | lo);
            if (vr) o += pj * vr[lane];
        }
    }
    OG[(size_t)row * QW + hq * 64 + lane] = o / l;
    if (lane == 0) LSE[(size_t)row * 18 + hq] = m + logf(l);
}
__global__ __launch_bounds__(256) void k_combine(float* OG, const float* LSE) {
    const int idx = blockIdx.x * 256 + threadIdx.x;
    if (idx >= MT * QW) return;
    const int row = idx / QW, c = idx % QW, hq = c >> 6, g = hq / 6, hh = hq % 6;
    const float l0 = LSE[(size_t)row * 18 + hh], l1 = LSE[(size_t)row * 18 + 6 + hh], l2 = LSE[(size_t)row * 18 + 12 + hh];
    const float mx = fmaxf(l0, fmaxf(l1, l2));
    const float e0 = expf(l0 - mx), e1 = expf(l1 - mx), e2 = expf(l2 - mx);
    const float a = (g == 0 ? e0 : (g == 1 ? e1 : e2)) / (e0 + e1 + e2);
    OG[idx] *= a;
}
}

extern "C" void kernel_launch(void* const* d_in, const int* in_sizes, int n_in, void* d_out, int out_size, void* d_ws, size_t ws_size, hipStream_t stream) {
    using namespace v1;
    const float* x_prompt = (const float*)d_in[0]; const float* x_sample = (const float*)d_in[1]; const float* cache_pool = (const float*)d_in[2];
    const float* cache_k = (const float*)d_in[3]; const float* cache_v = (const float*)d_in[4]; const float* gains = (const float*)d_in[5];
    const float* gkv = (const float*)d_in[6]; const float* w_pool = (const float*)d_in[7]; const float* pool_scale = (const float*)d_in[8];
    const float* w_q = (const float*)d_in[9]; const float* w_o = (const float*)d_in[10]; const float* w_kv = (const float*)d_in[11];
    const float* w_up = (const float*)d_in[12]; const float* w_down = (const float*)d_in[13];
    float* out = (float*)d_out;
    float* y = out;
    float* pool_prompt = out + (size_t)MT * D;
    float* k_prompt = pool_prompt + NPB * 15 * D;
    float* v_prompt = k_prompt + (size_t)NPB * CACHE * KVW;
    float* pool_sample = v_prompt + (size_t)NPB * CACHE * KVW;
    float* k_sample = pool_sample + (size_t)NSB * 15 * D;
    float* v_sample = k_sample + (size_t)MS * KVW;
    const size_t RB = (size_t)MT * D;
    float* R0 = (float*)d_ws; float* R1 = R0 + RB; float* R2 = R1 + RB; float* R3 = R2 + RB;
    constexpr int CH = 5504;
    float* F = R3 + RB;
    float* LSE = F + (size_t)CH * FF;
    const int rb = (MT + 3) / 4;
    auto G = [&](int l, int i) { return gains + ((size_t)l * 4 + i) * D; };

    hipMemcpyAsync(R0, x_prompt, (size_t)MP * D * 4, hipMemcpyDeviceToDevice, stream);
    hipMemcpyAsync(R0 + (size_t)MP * D, x_sample, (size_t)MS * D * 4, hipMemcpyDeviceToDevice, stream);
    k_rmsnorm<<<rb, 256, 0, stream>>>(R0, nullptr, G(0, 0), R1, nullptr, nullptr, MT);
    k_pool_out<<<(NPB * 15 * D + NSB * 15 * D + 255) / 256, 256, 0, stream>>>(R1, cache_pool, pool_prompt, pool_sample);
    k_pool_prep<<<MT, 256, 0, stream>>>(R1, cache_pool, R2);
    k_gemm<2><<<dim3(4, MT / 64, 4), 256, 0, stream>>>(R2, D, w_pool, 256, R1, D, 256, pool_scale, 256, 256 * 256, 256, 256);
    k_rmsnorm<<<rb, 256, 0, stream>>>(R1, R0, G(0, 1), R0, nullptr, nullptr, MT);
    k_rmsnorm<<<rb, 256, 0, stream>>>(R0, nullptr, G(0, 2), R1, nullptr, nullptr, MT);
    for (int c = 0; c < 3; ++c) {
        k_gemm<1><<<dim3(FF / 64, CH / 64, 1), 256, 0, stream>>>(R1 + (size_t)c * CH * D, D, w_up, FF, F, FF, D, nullptr, 0, 0, 0, 0);
        k_gemm<0><<<dim3(D / 64, CH / 64, 1), 256, 0, stream>>>(F, FF, w_down, D, R2 + (size_t)c * CH * D, D, FF, nullptr, 0, 0, 0, 0);
    }
    k_rmsnorm<<<rb, 256, 0, stream>>>(R2, R0, G(0, 3), R0, nullptr, nullptr, MT);
    k_rmsnorm<<<rb, 256, 0, stream>>>(R0, nullptr, G(1, 0), R1, gkv, R2, MT);
    float* Q = F;
    k_gemm<0><<<dim3(QW / 64, MT / 64, 1), 256, 0, stream>>>(R1, D, w_q, QW, Q, QW, D, nullptr, 0, 0, 0, 0);
    k_gemm<0><<<dim3(768 / 64, MT / 64, 1), 256, 0, stream>>>(R2, D, w_kv, 768, R3, 768, D, nullptr, 0, 0, 0, 0);
    float* KB = R1; float* VB = R1 + (size_t)MT * KVW;
    k_rope<<<(MT * 18 * 32 + 255) / 256, 256, 0, stream>>>(Q, QW, 0, Q, QW, 18);
    k_rope<<<(MT * 6 * 32 + 255) / 256, 256, 0, stream>>>(R3, 768, 0, KB, KVW, 6);
    k_copy_cols<<<(MT * KVW + 255) / 256, 256, 0, stream>>>(R3, 768, KVW, VB, KVW, KVW);
    for (int b = 0; b < NPB; ++b) {
        hipMemcpyAsync(k_prompt + (size_t)b * CACHE * KVW, KB + ((size_t)b * SEQ + SEQ - CACHE) * KVW, (size_t)CACHE * KVW * 4, hipMemcpyDeviceToDevice, stream);
        hipMemcpyAsync(v_prompt + (size_t)b * CACHE * KVW, VB + ((size_t)b * SEQ + SEQ - CACHE) * KVW, (size_t)CACHE * KVW * 4, hipMemcpyDeviceToDevice, stream);
    }
    hipMemcpyAsync(k_sample, KB + (size_t)MP * KVW, (size_t)MS * KVW * 4, hipMemcpyDeviceToDevice, stream);
    hipMemcpyAsync(v_sample, VB + (size_t)MP * KVW, (size_t)MS * KVW * 4, hipMemcpyDeviceToDevice, stream);
    float* OG = R2;
    k_attn<<<(MT * 18 + 3) / 4, 256, 0, stream>>>(Q, KB, VB, cache_k, cache_v, OG, LSE);
    k_combine<<<(MT * QW + 255) / 256, 256, 0, stream>>>(OG, LSE);
    k_gemm<0><<<dim3(D / 64, MT / 64, 1), 256, 0, stream>>>(OG, QW, w_o, D, R1, D, QW, nullptr, 0, 0, 0, 0);
    k_rmsnorm<<<rb, 256, 0, stream>>>(R1, R0, G(1, 1), R0, nullptr, nullptr, MT);
    k_rmsnorm<<<rb, 256, 0, stream>>>(R0, nullptr, G(1, 2), R1, nullptr, nullptr, MT);
    for (int c = 0; c < 3; ++c) {
        k_gemm<1><<<dim3(FF / 64, CH / 64, 1), 256, 0, stream>>>(R1 + (size_t)c * CH * D, D, w_up + (size_t)D * FF, FF, F, FF, D, nullptr, 0, 0, 0, 0);
        k_gemm<0><<<dim3(D / 64, CH / 64, 1), 256, 0, stream>>>(F, FF, w_down + (size_t)FF * D, D, R2 + (size_t)c * CH * D, D, FF, nullptr, 0, 0, 0, 0);
    }
    k_rmsnorm<<<rb, 256, 0, stream>>>(R2, R0, G(1, 3), y, nullptr, nullptr, MT);
}
```
